# Optimizing an MI355X kernel written in HIP

```python
import jax, jax.numpy as jnp
from jax import lax
import numpy as np

D_MODEL = 1024
BATCH = 8
SEQ = 4096
DEPTH = 4

CHUNK = 64
Q_BLOCK = 2 * CHUNK
N_MIXERS = 2
CONV_WIDTH = 3
MIX_WIDTH = D_MODEL
SB_HEADS = 16
SB_HEAD_DIM = MIX_WIDTH // SB_HEADS
N_MEM = 256
MEM_HEADS = 4
MEM_HEAD_DIM = 128
MEM_WIDTH = MEM_HEADS * MEM_HEAD_DIM
IN_WIDTH = 3 * MIX_WIDTH + MEM_WIDTH
OUT_WIDTH = MIX_WIDTH + MEM_WIDTH
D_FF = -(-(8 * D_MODEL) // (3 * 256)) * 256
N_CONV_LAYERS = (DEPTH + N_MIXERS - 1) // N_MIXERS
EPS = 1e-6

kernel_name = "hybrid_shortconv_stickbreaking_memxattn"


def rmsnorm(x, g):
    xf = x.astype(jnp.float32)
    y = xf * lax.rsqrt(jnp.mean(xf * xf, axis=-1, keepdims=True) + EPS)
    return (y * g.astype(jnp.float32)).astype(x.dtype)


def short_conv_mixer(b_gate, c_gate, u, w_conv):
    y = c_gate * u
    y = lax.conv_general_dilated(
        y, w_conv[:, None, :].astype(y.dtype),
        window_strides=(1,),
        padding=[(CONV_WIDTH - 1, 0)],
        dimension_numbers=("NWC", "WIO", "NWC"),
        feature_group_count=y.shape[-1])
    return b_gate * y


def stick_breaking_attention(q, k, v):
    b, h, s, dh = q.shape
    n_blk = s // Q_BLOCK
    scale = dh ** -0.5
    kf = k.astype(jnp.float32)
    vf = v.astype(jnp.float32)
    q_blocks = q.astype(jnp.float32).reshape(b, h, n_blk, Q_BLOCK, dh).transpose(2, 0, 1, 3, 4)
    key_pos = jnp.arange(s)

    def block(args):
        qb, t0 = args
        t = t0 + jnp.arange(Q_BLOCK)
        mask = key_pos[None, :] < t[:, None]
        z = jnp.einsum("bhqd,bhkd->bhqk", qb, kf) * scale
        log_keep = jnp.where(mask, jax.nn.log_sigmoid(-z), 0.0)
        later = lax.cumsum(log_keep, axis=3, reverse=True) - log_keep
        log_a = jax.nn.log_sigmoid(z) + later
        a = jnp.where(mask, jnp.exp(log_a), 0.0)
        return jnp.einsum("bhqk,bhkd->bhqd", a, vf)

    out = lax.map(block, (q_blocks, jnp.arange(n_blk) * Q_BLOCK))
    return out.transpose(1, 2, 0, 3, 4).reshape(b, h, s, dh).astype(q.dtype)


def memory_cross_attention(q, mem_kv, g_q, g_k):
    b, s, _ = q.shape
    m = mem_kv.shape[1]
    k, v = jnp.split(mem_kv, 2, axis=-1)
    qh = rmsnorm(q.reshape(b, s, MEM_HEADS, MEM_HEAD_DIM), g_q)
    kh = rmsnorm(k.reshape(b, m, MEM_HEADS, MEM_HEAD_DIM), g_k)
    vh = v.reshape(b, m, MEM_HEADS, MEM_HEAD_DIM)
    scores = jnp.einsum("bshd,bmhd->bhsm", qh, kh).astype(jnp.float32) * (MEM_HEAD_DIM ** -0.5)
    p = jax.nn.softmax(scores, axis=-1).astype(vh.dtype)
    o = jnp.einsum("bhsm,bmhd->bshd", p, vh)
    return o.reshape(b, s, MEM_WIDTH)


def setup_inputs(seed: int = 0) -> dict:
    key = jax.random.key(seed)
    ks = jax.random.split(key, 13)
    f32 = jnp.float32
    x = jax.random.normal(ks[0], (BATCH, SEQ, D_MODEL), f32)
    mem = jax.random.normal(ks[1], (BATCH, N_MEM, D_MODEL), f32)
    w_in = jax.random.normal(ks[2], (DEPTH, D_MODEL, IN_WIDTH), f32) * D_MODEL ** -0.5
    w_out = jax.random.normal(ks[3], (DEPTH, OUT_WIDTH, D_MODEL), f32) * OUT_WIDTH ** -0.5
    w_mem_kv = jax.random.normal(ks[4], (DEPTH, D_MODEL, 2 * MEM_WIDTH), f32) * D_MODEL ** -0.5
    w_conv = jax.random.normal(ks[5], (N_CONV_LAYERS, CONV_WIDTH, MIX_WIDTH), f32) * CONV_WIDTH ** -0.5
    w_ffn_in = jax.random.normal(ks[6], (DEPTH, D_MODEL, 2 * D_FF), f32) * D_MODEL ** -0.5
    w_ffn_out = jax.random.normal(ks[7], (DEPTH, D_FF, D_MODEL), f32) * D_FF ** -0.5
    g_mix = 1.0 + 0.02 * jax.random.normal(ks[8], (DEPTH, D_MODEL), f32)
    g_mem = 1.0 + 0.02 * jax.random.normal(ks[9], (DEPTH, D_MODEL), f32)
    g_ffn = 1.0 + 0.02 * jax.random.normal(ks[10], (DEPTH, D_MODEL), f32)
    g_q = 1.0 + 0.02 * jax.random.normal(ks[11], (DEPTH, MEM_HEAD_DIM), f32)
    g_k = 1.0 + 0.02 * jax.random.normal(ks[12], (DEPTH, MEM_HEAD_DIM), f32)
    return {"x": x, "mem": mem, "w_in": w_in, "w_out": w_out, "w_mem_kv": w_mem_kv,
            "w_conv": w_conv, "w_ffn_in": w_ffn_in, "w_ffn_out": w_ffn_out,
            "g_mix": g_mix, "g_mem": g_mem, "g_ffn": g_ffn, "g_q": g_q, "g_k": g_k}


def reference(x, mem, w_in, w_out, w_mem_kv, w_conv, w_ffn_in, w_ffn_out,
              g_mix, g_mem, g_ffn, g_q, g_k):
    b, s, _ = x.shape
    for i in range(DEPTH):
        h = rmsnorm(x, g_mix[i])
        proj = h @ w_in[i]
        p0, p1, p2 = jnp.split(proj[..., :3 * MIX_WIDTH], 3, axis=-1)
        q_mem = proj[..., 3 * MIX_WIDTH:]
        if i % N_MIXERS == 0:
            mixed = short_conv_mixer(p0, p1, p2, w_conv[i // N_MIXERS])
        else:
            def heads(t):
                return t.reshape(b, s, SB_HEADS, SB_HEAD_DIM).transpose(0, 2, 1, 3)
            o = stick_breaking_attention(heads(p0), heads(p1), heads(p2))
            mixed = o.transpose(0, 2, 1, 3).reshape(b, s, MIX_WIDTH)
        mem_kv = rmsnorm(mem, g_mem[i]) @ w_mem_kv[i]
        mem_out = memory_cross_attention(q_mem, mem_kv, g_q[i], g_k[i])
        x = x + jnp.concatenate([mixed, mem_out], axis=-1) @ w_out[i]
        h = rmsnorm(x, g_ffn[i])
        gate, up = jnp.split(h @ w_ffn_in[i], 2, axis=-1)
        x = x + (jax.nn.silu(gate) * up) @ w_ffn_out[i]
    return x
```

```cpp
#include <hip/hip_runtime.h>
#include <hip/hip_cooperative_groups.h>
#include <cstdio>
#include <cstdint>
namespace cg = cooperative_groups;

namespace pg8 {
#define PG8_LAS __attribute__((address_space(3)))
typedef unsigned short bf16_t;
typedef short bf16x8 __attribute__((ext_vector_type(8)));
typedef float f32x4 __attribute__((ext_vector_type(4)));
typedef unsigned u32x4 __attribute__((ext_vector_type(4)));
constexpr int BM = 256, BK = 64, HALF = 128, HTB = HALF * BK * 2  , STAGE_BYTES = 8 * HTB, NXCD = 8, WGM = 8;

__host__ __device__ __forceinline__ int lds_byte(int r, int c) { const int st = (r >> 4) * 2 + (c >> 5), rr = r & 15, cc = c & 31, ob = rr * 64 + cc * 2; return st * 1024 + (ob ^ (((ob >> 9) & 1) << 5)); }
__host__ __device__ __forceinline__ void stage_rc(int b, int& R, int& C) { const int st = b / 1024, sb = b % 1024, swz = sb ^ (((sb >> 9) & 1) << 5); R = (st >> 1) * 16 + swz / 64; C = (st & 1) * 32 + (swz % 64) / 2; }
__host__ __device__ __forceinline__ int perm32(int rho) { const int n = rho >> 4, i = rho & 15; return 8 * (i >> 2) + 4 * n + (i & 3); }

struct Unit { int pm, pn; };
struct Gemm { const bf16_t* A; const bf16_t* Bt; int M, N, K, lda; };

struct StaticOrder {
    int nM, nN, nwg, G, c;
    __host__ __device__ void init(int M, int N, int G_, int c_) { nM = M / BM; nN = N / BM; nwg = nM * nN; G = G_; c = c_; }
    __host__ __device__ bool next(int i, Unit& u) const {
        const long L = (long)i * G + c; if (L >= nwg) return false;
        int wgid = (int)L; { const int q = nwg / NXCD, r = nwg % NXCD, xcd = wgid % NXCD, off = wgid / NXCD; wgid = (xcd < r ? xcd * (q + 1) : r * (q + 1) + (xcd - r) * q) + off; }
        const int nig = WGM * nN, gid = wgid / nig, fm = gid * WGM, gsz = (nM - fm) < WGM ? (nM - fm) : WGM;
        u.pm = fm + ((wgid % nig) % gsz); u.pn = (wgid % nig) / gsz; return true;
    }
    __device__ __forceinline__ void a_ready(const Unit&) const {}
    __device__ __forceinline__ void done(const Unit&) const {}
};

typedef float f32x2_t __attribute__((ext_vector_type(2))); typedef __bf16 bf16x2_t __attribute__((ext_vector_type(2)));
__device__ __forceinline__ unsigned cvt_pk_bf16(float lo, float hi) { f32x2_t v = {lo, hi}; bf16x2_t b = __builtin_convertvector(v, bf16x2_t); return __builtin_bit_cast(unsigned, b); }

constexpr float RMS_EPS = 1e-6f;
struct EpiScale {
    static constexpr bool PERM = true, AFTER_DRAIN = false;
    bf16_t* O; int ldc; const float* sumsq;
    __device__ __forceinline__ void operator()(const f32x4 (&acc)[2][2][4][2], const Unit& u, int wr, int wc, int fr, int fq) const {
        const int row0 = u.pm * BM + wr * 64 + fr, col0 = u.pn * BM + wc * 32 + 8 * fq;
#pragma unroll
        for (int ai = 0; ai < 2; ++ai)
#pragma unroll
            for (int m = 0; m < 4; ++m) { const int row = row0 + ai * HALF + m * 16; float rs = 1.f; if (sumsq) rs = __builtin_amdgcn_rsqf(sumsq[row] * (1.f / 1024.f) + RMS_EPS);
                bf16_t* rowp = O + (size_t)row * ldc + col0;
#pragma unroll
                for (int bj = 0; bj < 2; ++bj) { const f32x4 v0 = acc[ai][bj][m][0] * rs, v1 = acc[ai][bj][m][1] * rs;
                    u32x4 w; w.x = cvt_pk_bf16(v0[0], v0[1]); w.y = cvt_pk_bf16(v0[2], v0[3]); w.z = cvt_pk_bf16(v1[0], v1[1]); w.w = cvt_pk_bf16(v1[2], v1[3]);
                    *(u32x4*)(rowp + bj * HALF) = w; } }
    }
};
__device__ __forceinline__ float silu_mul(float g, float u) { return g * __builtin_amdgcn_rcpf(1.f + __builtin_amdgcn_exp2f(-1.4426950408889634f * g)) * u; }
struct EpiSwiglu {
    static constexpr bool PERM = true, AFTER_DRAIN = false;
    bf16_t* H; int ldh; const float* sumsq;
    __device__ __forceinline__ void operator()(const f32x4 (&acc)[2][2][4][2], const Unit& u, int wr, int wc, int fr, int fq) const {
        const int row0 = u.pm * BM + wr * 64 + fr, col0 = u.pn * HALF + wc * 32 + 8 * fq;
#pragma unroll
        for (int ai = 0; ai < 2; ++ai)
#pragma unroll
            for (int m = 0; m < 4; ++m) { const int row = row0 + ai * HALF + m * 16; const float rs = __builtin_amdgcn_rsqf(sumsq[row] * (1.f / 1024.f) + RMS_EPS);
                const f32x4 g0 = acc[ai][0][m][0] * rs, g1 = acc[ai][0][m][1] * rs, u0 = acc[ai][1][m][0] * rs, u1 = acc[ai][1][m][1] * rs;
                u32x4 w; w.x = cvt_pk_bf16(silu_mul(g0[0], u0[0]), silu_mul(g0[1], u0[1])); w.y = cvt_pk_bf16(silu_mul(g0[2], u0[2]), silu_mul(g0[3], u0[3]));
                w.z = cvt_pk_bf16(silu_mul(g1[0], u1[0]), silu_mul(g1[1], u1[1])); w.w = cvt_pk_bf16(silu_mul(g1[2], u1[2]), silu_mul(g1[3], u1[3]));
                *(u32x4*)(H + (size_t)row * ldh + col0) = w; }
    }
};
struct EpiResid {
    static constexpr bool PERM = true, AFTER_DRAIN = false;
    const float* xin; float* xout; bf16_t* xb; float* ssq;
    __device__ __forceinline__ void operator()(const f32x4 (&acc)[2][2][4][2], const Unit& u, int wr, int wc, int fr, int fq) const {
        const int row0 = u.pm * BM + wr * 64 + fr, col0 = u.pn * BM + wc * 32 + 8 * fq;
#pragma unroll
        for (int ai = 0; ai < 2; ++ai)
#pragma unroll
            for (int m = 0; m < 4; ++m) { const int row = row0 + ai * HALF + m * 16; const size_t off = (size_t)row * 1024 + col0; float s = 0.f;
#pragma unroll
                for (int bj = 0; bj < 2; ++bj) { const f32x4 b0 = *(const f32x4*)(xin + off + bj * HALF), b1 = *(const f32x4*)(xin + off + bj * HALF + 4);
                    const f32x4 v0 = acc[ai][bj][m][0] + b0, v1 = acc[ai][bj][m][1] + b1;
                    *(f32x4*)(xout + off + bj * HALF) = v0; *(f32x4*)(xout + off + bj * HALF + 4) = v1;
                    u32x4 w; w.x = cvt_pk_bf16(v0[0], v0[1]); w.y = cvt_pk_bf16(v0[2], v0[3]); w.z = cvt_pk_bf16(v1[0], v1[1]); w.w = cvt_pk_bf16(v1[2], v1[3]);
                    *(u32x4*)(xb + off + bj * HALF) = w;
                    s += (v0[0] * v0[0] + v0[1] * v0[1]) + (v0[2] * v0[2] + v0[3] * v0[3]) + (v1[0] * v1[0] + v1[1] * v1[1]) + (v1[2] * v1[2] + v1[3] * v1[3]); }
                s += __shfl_xor(s, 16); s += __shfl_xor(s, 32);
                if (fq == 0) unsafeAtomicAdd(ssq + row, s); }
    }
};

template <class Epi, class Sched, bool ALIGN_EPI = false, bool SP2 = false>
__device__ __forceinline__ void gemm_phase(PG8_LAS unsigned char* lds, const Gemm g, const Sched& S, const Epi& E) {
    int tid_ = threadIdx.x; asm volatile("" : "+v"(tid_));
    const int tid = tid_, wid = __builtin_amdgcn_readfirstlane(tid >> 6), lane = tid & 63, wr = wid >> 2, wc = wid & 3, fr = lane & 15, fq = lane >> 4;
    const int K = g.K, nt = K / BK;
    unsigned voffA[2], voffB[2];
#pragma unroll
    for (int i = 0; i < 2; ++i) { int R, C; stage_rc(tid * 16 + i * 8192, R, C); const int Rb = Epi::PERM ? ((R & ~31) + perm32(R & 31)) : R;
        voffA[i] = (unsigned)(R * g.lda + C) * 2u; voffB[i] = (unsigned)(Rb * K + C) * 2u; }
    const size_t kstep = (size_t)(BK * 2);
    const size_t hstepA = (size_t)HALF * g.lda * 2, hstepB = (size_t)HALF * K * 2;
    const size_t tstepA = 2 * hstepA, tstepB = 2 * hstepB;
    const unsigned ldsw = (unsigned)wid * 1024u;
    const int aoff = lds_byte(wr * 64 + fr, fq * 8), boff = lds_byte(wc * 32 + fr, fq * 8);
#define PG8_SA(b, h) (((b) * 2 + (h)) * HTB)
#define PG8_SB(b, h) ((4 + (b) * 2 + (h)) * HTB)
#define PG8_STAGE(bufoff, gbase, voff) do { _Pragma("unroll") for (int _i = 0; _i < 2; ++_i) \
        __builtin_amdgcn_global_load_lds((const unsigned*)((const char*)(gbase) + (voff)[_i]), (PG8_LAS unsigned*)(lds + (bufoff) + ldsw + _i * 8192), 16, 0, 0); } while (0)
#define PG8_LDA(dst, b, h) do { _Pragma("unroll") for (int m = 0; m < 4; ++m) _Pragma("unroll") for (int k = 0; k < 2; ++k) dst[m][k] = *(const PG8_LAS bf16x8*)(lds + PG8_SA(b, h) + aoff + m * 2048 + k * 1024); } while (0)
#define PG8_LDB(dst, b, h) do { _Pragma("unroll") for (int n = 0; n < 2; ++n) _Pragma("unroll") for (int k = 0; k < 2; ++k) dst[n][k] = *(const PG8_LAS bf16x8*)(lds + PG8_SB(b, h) + boff + n * 2048 + k * 1024); } while (0)
#define PG8_MMA(ai, bj, At, Bt) do { __builtin_amdgcn_s_setprio(1); _Pragma("unroll") for (int m = 0; m < 4; ++m) _Pragma("unroll") for (int n = 0; n < 2; ++n) _Pragma("unroll") for (int k = 0; k < 2; ++k) \
        acc[ai][bj][m][n] = __builtin_amdgcn_mfma_f32_16x16x32_bf16(Bt[n][k], At[m][k], acc[ai][bj][m][n], 0, 0, 0); __builtin_amdgcn_s_setprio(0); } while (0)
#define PG8_WAIT_V(n) asm volatile("s_waitcnt vmcnt(" #n ")" ::: "memory")
#define PG8_WAIT_L(n) asm volatile("s_waitcnt lgkmcnt(" #n ")" ::: "memory")
#define PG8_BAR __builtin_amdgcn_s_barrier()
#define PG8_SCHED __builtin_amdgcn_sched_barrier(0)
    Unit cur, nxt; int ui = 0;
    if (!S.next(0, cur)) return;
    f32x4 acc[2][2][4][2];
#pragma unroll
    for (int a = 0; a < 2; ++a)
#pragma unroll
        for (int b = 0; b < 2; ++b)
#pragma unroll
            for (int m = 0; m < 4; ++m)
#pragma unroll
                for (int n = 0; n < 2; ++n) acc[a][b][m][n] = (f32x4){0.f, 0.f, 0.f, 0.f};
    bf16x8 At[4][2], B0[2][2], B1[2][2];
    const char* cA = (const char*)g.A + (size_t)cur.pm * tstepA; const char* cB = (const char*)g.Bt + (size_t)cur.pn * tstepB;
    S.a_ready(cur);
    if constexpr (SP2) {
        PG8_STAGE(PG8_SB(0, 0), cB, voffB); PG8_STAGE(PG8_SB(0, 1), cB + hstepB, voffB); PG8_STAGE(PG8_SA(0, 0), cA, voffA); PG8_STAGE(PG8_SA(0, 1), cA + hstepA, voffA);
        if (wr == 1) PG8_BAR;
        PG8_WAIT_V(2); PG8_BAR;
        PG8_STAGE(PG8_SB(1, 0), cB + kstep, voffB); PG8_STAGE(PG8_SA(1, 0), cA + kstep, voffA); PG8_STAGE(PG8_SB(1, 1), cB + hstepB + kstep, voffB);
        PG8_WAIT_V(6); PG8_BAR;
    } else {
        PG8_STAGE(PG8_SB(0, 0), cB, voffB); PG8_STAGE(PG8_SA(0, 0), cA, voffA); PG8_STAGE(PG8_SB(0, 1), cB + hstepB, voffB); PG8_STAGE(PG8_SA(0, 1), cA + hstepA, voffA);
        if (wr == 1) PG8_BAR;
        PG8_WAIT_V(4); PG8_BAR;
        PG8_STAGE(PG8_SB(1, 0), cB + kstep, voffB); PG8_STAGE(PG8_SA(1, 0), cA + kstep, voffA); PG8_STAGE(PG8_SB(1, 1), cB + hstepB + kstep, voffB);
        PG8_WAIT_V(6); PG8_BAR;
    }
    for (;;) {
        const bool has_next = S.next(ui + 1, nxt);
        const char* nA = has_next ? (const char*)g.A + (size_t)nxt.pm * tstepA : cA; const char* nB = has_next ? (const char*)g.Bt + (size_t)nxt.pn * tstepB : cB;
        for (int t = 0; t < nt; t += 2) {
            const bool last = (t == nt - 2);
            const char* a1 = cA + (size_t)(t + 1) * kstep;
            const char* a2 = last ? nA : cA + (size_t)(t + 2) * kstep; const char* b2 = last ? nB : cB + (size_t)(t + 2) * kstep;
            const char* a3 = a2 + kstep; const char* b3 = b2 + kstep;
            if (last && has_next) S.a_ready(nxt);
            if constexpr (SP2) {
            PG8_LDB(B0, 0, 0); PG8_LDB(B1, 0, 1); PG8_SCHED; PG8_LDA(At, 0, 0); PG8_STAGE(PG8_SA(1, 1), a1 + hstepA, voffA);
            PG8_WAIT_V(8); PG8_WAIT_L(0); PG8_BAR; PG8_MMA(0, 0, At, B0); PG8_MMA(0, 1, At, B1); PG8_BAR; PG8_SCHED;
            PG8_LDA(At, 0, 1); PG8_STAGE(PG8_SB(0, 0), b2, voffB); PG8_STAGE(PG8_SB(0, 1), b2 + hstepB, voffB); PG8_STAGE(PG8_SA(0, 0), a2, voffA);
            PG8_WAIT_V(8); PG8_WAIT_L(0); PG8_BAR; PG8_MMA(1, 0, At, B0); PG8_MMA(1, 1, At, B1); PG8_BAR; PG8_SCHED;
            PG8_LDB(B0, 1, 0); PG8_LDB(B1, 1, 1); PG8_SCHED; PG8_LDA(At, 1, 0); PG8_STAGE(PG8_SA(0, 1), a2 + hstepA, voffA);
            PG8_WAIT_V(8); PG8_WAIT_L(0); PG8_BAR; PG8_MMA(0, 0, At, B0); PG8_MMA(0, 1, At, B1); PG8_BAR; PG8_SCHED;
            PG8_LDA(At, 1, 1); PG8_STAGE(PG8_SB(1, 0), b3, voffB); PG8_STAGE(PG8_SB(1, 1), b3 + hstepB, voffB); PG8_STAGE(PG8_SA(1, 0), a3, voffA);
            PG8_WAIT_V(8); PG8_WAIT_L(0); PG8_BAR; PG8_MMA(1, 0, At, B0); PG8_MMA(1, 1, At, B1); PG8_BAR; PG8_SCHED;
            } else {
            PG8_LDB(B0, 0, 0); PG8_SCHED; PG8_LDA(At, 0, 0); PG8_STAGE(PG8_SA(1, 1), a1 + hstepA, voffA);
            PG8_WAIT_L(8); PG8_BAR; PG8_WAIT_L(0); PG8_MMA(0, 0, At, B0); PG8_BAR; PG8_SCHED;
            PG8_LDB(B1, 0, 1); PG8_STAGE(PG8_SB(0, 0), b2, voffB);
            PG8_BAR; PG8_WAIT_L(0); PG8_MMA(0, 1, At, B1); PG8_BAR;
            PG8_LDA(At, 0, 1); PG8_STAGE(PG8_SA(0, 0), a2, voffA);
            PG8_BAR; PG8_WAIT_L(0); PG8_MMA(1, 0, At, B0); PG8_BAR; PG8_SCHED;
            PG8_STAGE(PG8_SB(0, 1), b2 + hstepB, voffB);
            PG8_WAIT_V(6); PG8_BAR; PG8_MMA(1, 1, At, B1); PG8_BAR;
            PG8_LDB(B0, 1, 0); PG8_SCHED; PG8_LDA(At, 1, 0); PG8_STAGE(PG8_SA(0, 1), a2 + hstepA, voffA);
            PG8_WAIT_L(8); PG8_BAR; PG8_WAIT_L(0); PG8_MMA(0, 0, At, B0); PG8_BAR; PG8_SCHED;
            PG8_LDB(B1, 1, 1); PG8_STAGE(PG8_SB(1, 0), b3, voffB);
            PG8_BAR; PG8_WAIT_L(0); PG8_MMA(0, 1, At, B1); PG8_BAR;
            PG8_LDA(At, 1, 1); PG8_STAGE(PG8_SA(1, 0), a3, voffA);
            PG8_BAR; PG8_WAIT_L(0); PG8_MMA(1, 0, At, B0); PG8_BAR; PG8_SCHED;
            PG8_STAGE(PG8_SB(1, 1), b3 + hstepB, voffB);
            PG8_WAIT_V(6); PG8_BAR; PG8_MMA(1, 1, At, B1); PG8_BAR;
            }
        }
        if constexpr (ALIGN_EPI) { if (wr == 0) PG8_BAR; }
        if constexpr (!Epi::AFTER_DRAIN) { E(acc, cur, wr, wc, fr, fq); S.done(cur); }
        if (!has_next) break;
#pragma unroll
        for (int a = 0; a < 2; ++a)
#pragma unroll
            for (int b = 0; b < 2; ++b)
#pragma unroll
                for (int m = 0; m < 4; ++m)
#pragma unroll
                    for (int n = 0; n < 2; ++n) acc[a][b][m][n] = (f32x4){0.f, 0.f, 0.f, 0.f};
        cur = nxt; cA = nA; cB = nB; ++ui;
        if constexpr (ALIGN_EPI) { if (wr == 1) PG8_BAR; }
    }
    PG8_WAIT_V(0);
    if constexpr (!ALIGN_EPI) { if (wr == 0) PG8_BAR; }
    PG8_BAR;
    if constexpr (Epi::AFTER_DRAIN) { E.fused(acc, cur, wr, wc, fr, fq, lds, wid, lane); S.done(cur); }
#undef PG8_SA
#undef PG8_SB
#undef PG8_STAGE
#undef PG8_LDA
#undef PG8_LDB
#undef PG8_MMA
#undef PG8_WAIT_V
#undef PG8_WAIT_L
#undef PG8_BAR
#undef PG8_SCHED
}
}

#define LAS __attribute__((address_space(3)))
typedef unsigned short bf16;
typedef short bf16x8 __attribute__((ext_vector_type(8)));
typedef short s16x4 __attribute__((ext_vector_type(4)));
typedef float f32x4 __attribute__((ext_vector_type(4)));
typedef float f32x16 __attribute__((ext_vector_type(16)));
typedef unsigned u32x4 __attribute__((ext_vector_type(4)));
typedef unsigned u32x2 __attribute__((ext_vector_type(2)));

constexpr int DM = 1024, NBATCH = 8, SEQ = 4096, MTOK = NBATCH * SEQ, DEPTH = 4;
constexpr int PW = 3584;
constexpr int C_P0 = 0, C_QM = 1024, C_P1 = 1536, C_P2 = 2560;
constexpr int KOUT = 1536, DFF = 2816, NFF = 5632, NMEM = 256, MROWS = NBATCH * NMEM, MKVW = DEPTH * 1024;
constexpr float EPS = 1e-6f, LOG2E = 1.4426950408889634f, LN2 = 0.6931471805599453f;
constexpr int NWAVES = 8, NTHREADS = 512;

constexpr size_t MiB = 1u << 20;
constexpr size_t WS_SSQ = 0;
constexpr size_t WS_WIN = 2 * MiB, WS_WOUT = 30 * MiB, WS_WFI = 42 * MiB, WS_WFO = 86 * MiB, WS_WKV = 108 * MiB;
constexpr size_t WS_MEMN = 116 * MiB, WS_MKV = 120 * MiB, WS_XB = 136 * MiB, WS_PROJ = 200 * MiB, WS_HID = 200 * MiB, WS_END = 424 * MiB;
constexpr size_t SZ_WIN = (size_t)PW * DM * 2, SZ_WOUT = (size_t)DM * KOUT * 2, SZ_WFI = (size_t)NFF * DM * 2, SZ_WFO = (size_t)DM * DFF * 2;
static_assert(WS_WIN + 4 * SZ_WIN <= WS_WOUT && WS_WOUT + 4 * SZ_WOUT <= WS_WFI && WS_WFI + 4 * SZ_WFI <= WS_WFO && WS_WFO + 4 * SZ_WFO <= WS_WKV, "weight map");
static_assert(WS_PROJ + (size_t)MTOK * PW * 2 <= WS_END && WS_HID + (size_t)MTOK * DFF * 2 <= WS_END && 9 * (size_t)MTOK * 4 <= WS_WIN, "map");

constexpr int RING_BYTES = 131072, LDS_BYTES = 147456;
constexpr int XK_STR = 272, XV_STR = 288, XK_OFF = 0, XV_OFF = 256 * XK_STR, XW_OFF = XV_OFF + 256 * XV_STR;
static_assert(XW_OFF + NWAVES * 128 <= LDS_BYTES, "cross LDS");
constexpr int SBV_STR = 144;

struct Args { const float* in[13]; float* out; unsigned char* ws; };

#define LDS_WAIT() asm volatile("s_waitcnt lgkmcnt(0)" ::: "memory")
__device__ __forceinline__ unsigned pk2(float lo, float hi) { return pg8::cvt_pk_bf16(lo, hi); }
__device__ __forceinline__ float bf_lo(unsigned u) { return __uint_as_float(u << 16); }
__device__ __forceinline__ float bf_hi(unsigned u) { return __uint_as_float(u & 0xffff0000u); }
__device__ __forceinline__ int crow(int r, int hh) { return (r & 3) + 8 * (r >> 2) + 4 * hh; }
__device__ __forceinline__ float wave_sum(float v) {
#pragma unroll
    for (int o = 1; o < 64; o <<= 1) v += __shfl_xor(v, o);
    return v;
}
__device__ __forceinline__ float partner_val(float v, int hh) { auto rr = __builtin_amdgcn_permlane32_swap(__float_as_uint(v), __float_as_uint(v), false, false); return __uint_as_float(hh ? rr[0] : rr[1]); }
__device__ __forceinline__ float pair_sum(float v) { auto rr = __builtin_amdgcn_permlane32_swap(__float_as_uint(v), __float_as_uint(v), false, false); return __uint_as_float(rr[0]) + __uint_as_float(rr[1]); }
typedef short v4i16_t __attribute__((ext_vector_type(4)));
__device__ __forceinline__ s16x4 tr16(LAS const unsigned char* p) { return __builtin_bit_cast(s16x4, __builtin_amdgcn_ds_read_tr16_b64_v4i16((LAS v4i16_t*)p)); }
#define MFMA32(a, b, c) __builtin_amdgcn_mfma_f32_32x32x16_bf16((a), (b), (c), 0, 0, 0)

__device__ __forceinline__ void tr_item(const float* W, int K, int N, bf16* WT, int k0, int n0, int drow0, const float* g, LAS float* scr, int lane) {
#pragma unroll 8
    for (int i = 0; i < 32; ++i) { const int kk = 2 * i + (lane >> 5); float v = W[(size_t)(k0 + kk) * N + n0 + (lane & 31)]; if (g) v *= g[k0 + kk]; scr[kk * 33 + (lane & 31)] = v; }
    LDS_WAIT(); asm volatile("" ::: "memory");
    const int c = lane & 7;
#pragma unroll
    for (int j = 0; j < 4; ++j) { const int n = (lane >> 3) + 8 * j; const LAS float* s = scr + (8 * c) * 33 + n;
        u32x4 o; o.x = pk2(s[0 * 33], s[1 * 33]); o.y = pk2(s[2 * 33], s[3 * 33]); o.z = pk2(s[4 * 33], s[5 * 33]); o.w = pk2(s[6 * 33], s[7 * 33]);
        *(u32x4*)(WT + (size_t)(drow0 + n) * K + k0 + 8 * c) = o; }
    LDS_WAIT(); asm volatile("" ::: "memory");
}
__device__ __forceinline__ void prologue(const Args& a, LAS unsigned char* lds, int wave, int lane, int tid) {
    asm volatile("" : "+v"(lane), "+v"(tid));
    unsigned char* ws = a.ws;
    LAS float* scr = (LAS float*)(lds + wave * 16384);
    const int gw = blockIdx.x * NWAVES + wave, NGW = gridDim.x * NWAVES;
    constexpr int I_IN = 16 * 112, I_OUT = 24 * 32, I_FI = 16 * 176, I_FO = 44 * 32, I_KV = 16 * 32, I_LAYER = I_IN + I_OUT + I_FI + I_FO + I_KV;
    for (int it = gw; it < DEPTH * I_LAYER; it += NGW) {
        const int L = it / I_LAYER; int r = it - L * I_LAYER;
        if (r < I_IN) { const int kb = r / 112, nb = r % 112, n0 = nb * 32;
            const int d = n0 < 1024 ? C_P0 + n0 : n0 < 2048 ? C_P1 + (n0 - 1024) : n0 < 3072 ? C_P2 + (n0 - 2048) : C_QM + (n0 - 3072);
            tr_item(a.in[2] + (size_t)L * DM * PW, DM, PW, (bf16*)(ws + WS_WIN + L * SZ_WIN), kb * 64, n0, d, a.in[8] + L * DM, scr, lane); continue; }
        r -= I_IN;
        if (r < I_OUT) { const int kb = r / 32, nb = r % 32;
            tr_item(a.in[3] + (size_t)L * KOUT * DM, KOUT, DM, (bf16*)(ws + WS_WOUT + L * SZ_WOUT), kb * 64, nb * 32, nb * 32, nullptr, scr, lane); continue; }
        r -= I_OUT;
        if (r < I_FI) { const int kb = r / 176, nb = r % 176, n0 = nb * 32; const int hcol = n0 < DFF ? n0 : n0 - DFF;
            const int d = 256 * (hcol >> 7) + (hcol & 127) + (n0 < DFF ? 0 : 128);
            tr_item(a.in[6] + (size_t)L * DM * NFF, DM, NFF, (bf16*)(ws + WS_WFI + L * SZ_WFI), kb * 64, n0, d, a.in[10] + L * DM, scr, lane); continue; }
        r -= I_FI;
        if (r < I_FO) { const int kb = r / 32, nb = r % 32;
            tr_item(a.in[7] + (size_t)L * DFF * DM, DFF, DM, (bf16*)(ws + WS_WFO + L * SZ_WFO), kb * 64, nb * 32, nb * 32, nullptr, scr, lane); continue; }
        r -= I_FO;
        { const int kb = r / 32, nb = r % 32;
            tr_item(a.in[4] + (size_t)L * DM * 1024, DM, 1024, (bf16*)(ws + WS_WKV), kb * 64, nb * 32, L * 1024 + nb * 32, a.in[9] + L * DM, scr, lane); }
    }
    float* ssq = (float*)(ws + WS_SSQ); bf16* xb = (bf16*)(ws + WS_XB);
    for (int m = gw; m < MTOK; m += NGW) {
        const f32x4* xr = (const f32x4*)(a.in[0] + (size_t)m * DM) + lane; f32x4 v[4]; float s = 0.f;
#pragma unroll
        for (int j = 0; j < 4; ++j) { v[j] = xr[64 * j]; s += (v[j].x * v[j].x + v[j].y * v[j].y) + (v[j].z * v[j].z + v[j].w * v[j].w); }
        s = wave_sum(s);
        u32x2* o8 = (u32x2*)(xb + (size_t)m * DM) + lane;
#pragma unroll
        for (int j = 0; j < 4; ++j) { u32x2 w; w.x = pk2(v[j].x, v[j].y); w.y = pk2(v[j].z, v[j].w); o8[64 * j] = w; }
        if (lane == 0) ssq[m] = s;
    }
    bf16* memn = (bf16*)(ws + WS_MEMN);
    for (int m = gw; m < MROWS; m += NGW) {
        const f32x4* xr = (const f32x4*)(a.in[1] + (size_t)m * DM) + lane; f32x4 v[4]; float s = 0.f;
#pragma unroll
        for (int j = 0; j < 4; ++j) { v[j] = xr[64 * j]; s += (v[j].x * v[j].x + v[j].y * v[j].y) + (v[j].z * v[j].z + v[j].w * v[j].w); }
        const float rs = __builtin_amdgcn_rsqf(wave_sum(s) * (1.f / DM) + EPS);
        u32x2* o8 = (u32x2*)(memn + (size_t)m * DM) + lane;
#pragma unroll
        for (int j = 0; j < 4; ++j) { u32x2 w; w.x = pk2(v[j].x * rs, v[j].y * rs); w.y = pk2(v[j].z * rs, v[j].w * rs); o8[64 * j] = w; }
    }
    for (int i = blockIdx.x * NTHREADS + tid; i < 8 * MTOK; i += gridDim.x * NTHREADS) ssq[MTOK + i] = 0.f;
}

__device__ __forceinline__ void conv_phase(bf16* proj, const float* wc, int tid) {
    asm volatile("" : "+v"(tid));
    const int NT = gridDim.x * NTHREADS;
    for (int task = blockIdx.x * NTHREADS + tid; task < (MTOK / 32) * 128; task += NT) {
        const int cgp = task & 127, chunk = task >> 7, t0 = chunk * 32, c0 = cgp * 8;
        float w0[8], w1[8], w2[8], m2[8], m1[8];
#pragma unroll
        for (int e = 0; e < 8; ++e) { w0[e] = wc[c0 + e]; w1[e] = wc[1024 + c0 + e]; w2[e] = wc[2048 + c0 + e]; m2[e] = 0.f; m1[e] = 0.f; }
        if ((t0 & (SEQ - 1)) != 0) {
            const u32x4 a1 = *(const u32x4*)(proj + (size_t)(t0 - 2) * PW + C_P1 + c0), a2 = *(const u32x4*)(proj + (size_t)(t0 - 2) * PW + C_P2 + c0);
            const u32x4 b1 = *(const u32x4*)(proj + (size_t)(t0 - 1) * PW + C_P1 + c0), b2 = *(const u32x4*)(proj + (size_t)(t0 - 1) * PW + C_P2 + c0);
#pragma unroll
            for (int e = 0; e < 4; ++e) { m2[2 * e] = bf_lo(a1[e]) * bf_lo(a2[e]); m2[2 * e + 1] = bf_hi(a1[e]) * bf_hi(a2[e]); m1[2 * e] = bf_lo(b1[e]) * bf_lo(b2[e]); m1[2 * e + 1] = bf_hi(b1[e]) * bf_hi(b2[e]); }
        }
#pragma unroll 4
        for (int t = t0; t < t0 + 32; ++t) {
            bf16* rp = proj + (size_t)t * PW + c0;
            const u32x4 q1 = *(const u32x4*)(rp + C_P1), q2 = *(const u32x4*)(rp + C_P2), q0 = *(const u32x4*)(rp + C_P0);
            float cu[8], y[8];
#pragma unroll
            for (int e = 0; e < 4; ++e) { cu[2 * e] = bf_lo(q1[e]) * bf_lo(q2[e]); cu[2 * e + 1] = bf_hi(q1[e]) * bf_hi(q2[e]); }
#pragma unroll
            for (int e = 0; e < 8; ++e) y[e] = w0[e] * m2[e] + w1[e] * m1[e] + w2[e] * cu[e];
            u32x4 o;
#pragma unroll
            for (int e = 0; e < 4; ++e) o[e] = pk2(bf_lo(q0[e]) * y[2 * e], bf_hi(q0[e]) * y[2 * e + 1]);
            *(u32x4*)(rp + C_P0) = o;
#pragma unroll
            for (int e = 0; e < 8; ++e) { m2[e] = m1[e]; m1[e] = cu[e]; }
        }
    }
}

constexpr float SB_EXIT = 104.0f;
__device__ __forceinline__ void sb_phase(bf16* proj, LAS unsigned char* lds, int wave, int lane) {
    asm volatile("" : "+v"(lane));
    const int r32 = lane & 31, hh = lane >> 5;
    LAS unsigned char* vl = lds + wave * (32 * SBV_STR);
    const int i16 = lane & 15, tq = i16 >> 2, tp = i16 & 3, blk = (lane >> 4) & 1;
    LAS const unsigned char* vrd = vl + (4 * hh + tq) * SBV_STR + (16 * blk + 4 * tp) * 2;
    const int gw = blockIdx.x * NWAVES + wave, NGW = gridDim.x * NWAVES;
    for (int u = gw; u < NBATCH * 16 * (SEQ / 32); u += NGW) {
        const int qb = u & 127, h = (u >> 7) & 15, b = u >> 11;
        const size_t row0 = (size_t)b * SEQ; const int q0 = qb * 32;
        const bf16* Qp = proj + (row0 + q0 + r32) * PW + C_P0 + h * 64 + hh * 8;
        bf16x8 qf[4];
#pragma unroll
        for (int d0 = 0; d0 < 4; ++d0) qf[d0] = *(const bf16x8*)(Qp + d0 * 16);
        f32x16 o0, o1;
#pragma unroll
        for (int r = 0; r < 16; ++r) { o0[r] = 0.f; o1[r] = 0.f; }
        float carry = 0.f;
        for (int kb = qb; kb >= 0; --kb) {
            const bf16* Kp = proj + (row0 + kb * 32 + r32) * PW + C_P1 + h * 64 + hh * 8;
            bf16x8 kf[4];
#pragma unroll
            for (int d0 = 0; d0 < 4; ++d0) kf[d0] = *(const bf16x8*)(Kp + d0 * 16);
            u32x4 vv[4];
#pragma unroll
            for (int i = 0; i < 4; ++i) { const int c = i * 64 + lane, vr = c >> 3, vc = c & 7; vv[i] = *(const u32x4*)(proj + (row0 + kb * 32 + vr) * PW + C_P2 + h * 64 + vc * 8); }
            f32x16 z;
#pragma unroll
            for (int r = 0; r < 16; ++r) z[r] = 0.f;
#pragma unroll
            for (int d0 = 0; d0 < 4; ++d0) z = MFMA32(kf[d0], qf[d0], z);
#pragma unroll
            for (int i = 0; i < 4; ++i) { const int c = i * 64 + lane, vr = c >> 3, vc = c & 7; *(LAS u32x4*)(vl + vr * SBV_STR + vc * 16) = vv[i]; }
            float zz[16], t[16], S[5], P[5];
            const bool diag = (kb == qb);
#pragma unroll
            for (int r = 0; r < 16; ++r) { const float zv = z[r] * 0.125f; zz[r] = zv;
                const float e = __builtin_amdgcn_exp2f(-fabsf(zv) * LOG2E);
                float sp = fmaxf(zv, 0.f) + __builtin_amdgcn_logf(1.f + e) * LN2;
                if (diag && !(crow(r, hh) < r32)) sp = 0.f;
                t[r] = sp; }
            S[4] = 0.f; P[4] = 0.f;
#pragma unroll
            for (int g = 3; g >= 0; --g) { t[4 * g + 2] += t[4 * g + 3]; t[4 * g + 1] += t[4 * g + 2]; t[4 * g] += t[4 * g + 1]; S[g] = t[4 * g] + S[g + 1]; }
#pragma unroll
            for (int g = 0; g < 4; ++g) P[g] = partner_val(S[g], hh);
            float av[16];
#pragma unroll
            for (int g = 0; g < 4; ++g) { const float off = carry + S[g + 1] + (hh ? P[g + 1] : P[g]);
#pragma unroll
                for (int i = 0; i < 4; ++i) { const int r = 4 * g + i; float aa = __builtin_amdgcn_exp2f((zz[r] - (off + t[r])) * LOG2E);
                    if (diag && !(crow(r, hh) < r32)) aa = 0.f;
                    av[r] = aa; } }
            carry += S[0] + P[0];
            bf16x8 pa0, pa1;
            { u32x4 w0, w1;
#pragma unroll
              for (int e = 0; e < 4; ++e) { w0[e] = pk2(av[2 * e], av[2 * e + 1]); w1[e] = pk2(av[8 + 2 * e], av[8 + 2 * e + 1]); }
              pa0 = __builtin_bit_cast(bf16x8, w0); pa1 = __builtin_bit_cast(bf16x8, w1); }
            { const s16x4 l00 = tr16(vrd), h00 = tr16(vrd + 8 * SBV_STR), l01 = tr16(vrd + 16 * SBV_STR), h01 = tr16(vrd + 24 * SBV_STR);
              const s16x4 l10 = tr16(vrd + 64), h10 = tr16(vrd + 8 * SBV_STR + 64), l11 = tr16(vrd + 16 * SBV_STR + 64), h11 = tr16(vrd + 24 * SBV_STR + 64);
#define SB_VF(lo, hi) (bf16x8){lo[0], lo[1], lo[2], lo[3], hi[0], hi[1], hi[2], hi[3]}
              o0 = MFMA32(pa0, SB_VF(l00, h00), o0); o0 = MFMA32(pa1, SB_VF(l01, h01), o0);
              o1 = MFMA32(pa0, SB_VF(l10, h10), o1); o1 = MFMA32(pa1, SB_VF(l11, h11), o1); }
            if (!__any(carry <= SB_EXIT)) break;
        }
        bf16* Op = proj + (row0 + q0) * PW + C_P0 + h * 64 + r32;
#pragma unroll
        for (int r = 0; r < 16; ++r) { bf16* p = Op + (size_t)crow(r, hh) * PW; p[0] = (bf16)(pk2(o0[r], 0.f) & 0xffffu); p[32] = (bf16)(pk2(o1[r], 0.f) & 0xffffu); }
    }
}

__device__ __forceinline__ void cross_phase(bf16* proj, const bf16* mkv, const float* gq, const float* gk, int L, LAS unsigned char* lds, int wave, int lane, int tid) {
    asm volatile("" : "+v"(lane), "+v"(tid));
    const int r32 = lane & 31, hh = lane >> 5;
    LAS unsigned char* KL = lds + XK_OFF; LAS unsigned char* VL = lds + XV_OFF; LAS float* wsf = (LAS float*)(lds + XW_OFF) + wave * 32;
    float gm = fmaxf(fabsf(gq[lane] * gk[lane]), fabsf(gq[lane + 64] * gk[lane + 64]));
#pragma unroll
    for (int o = 1; o < 64; o <<= 1) gm = fmaxf(gm, __shfl_xor(gm, o));
    const float SCL = 0.08838834764831845f * LOG2E, MB = gm * 11.313708498984761f * LOG2E;
    const int i16 = lane & 15, tq = i16 >> 2, tp = i16 & 3, blk = (lane >> 4) & 1;
    LAS const unsigned char* vrd = VL + (4 * hh + tq) * XV_STR + (16 * blk + 4 * tp) * 2;
    LAS const unsigned char* krd = KL + r32 * XK_STR + hh * 16;
    int cur = -1;
    for (int u = blockIdx.x; u < 512; u += gridDim.x) {
        const int bh = u & 31, tile = u >> 5, b = bh >> 2, h = bh & 3;
        if (bh != cur) {
            __syncthreads();
            const bf16* kv = mkv + (size_t)(b * NMEM) * MKVW + L * 1024 + h * 128;
            const int c16 = tid & 15, kr = tid >> 4;
            float gg[8];
#pragma unroll
            for (int e = 0; e < 8; ++e) gg[e] = gq[c16 * 8 + e] * gk[c16 * 8 + e];
#pragma unroll 2
            for (int ps = 0; ps < 8; ++ps) { const int key = ps * 32 + kr;
                const u32x4 kraw = *(const u32x4*)(kv + (size_t)key * MKVW + c16 * 8), vraw = *(const u32x4*)(kv + (size_t)key * MKVW + 512 + c16 * 8);
                float f[8]; float ss = 0.f;
#pragma unroll
                for (int e = 0; e < 4; ++e) { f[2 * e] = bf_lo(kraw[e]); f[2 * e + 1] = bf_hi(kraw[e]); ss += f[2 * e] * f[2 * e] + f[2 * e + 1] * f[2 * e + 1]; }
                ss += __shfl_xor(ss, 1); ss += __shfl_xor(ss, 2); ss += __shfl_xor(ss, 4); ss += __shfl_xor(ss, 8);
                const float rk = __builtin_amdgcn_rsqf(ss * (1.f / 128.f) + EPS);
                u32x4 kw;
#pragma unroll
                for (int e = 0; e < 4; ++e) kw[e] = pk2(f[2 * e] * rk * gg[2 * e], f[2 * e + 1] * rk * gg[2 * e + 1]);
                *(LAS u32x4*)(KL + key * XK_STR + c16 * 16) = kw; *(LAS u32x4*)(VL + key * XV_STR + c16 * 16) = vraw; }
            __syncthreads();
            cur = bh;
        }
        const size_t qrow = (size_t)b * SEQ + tile * 256 + wave * 32;
        bf16* Qp = proj + (qrow + r32) * PW + C_QM + h * 128 + hh * 8;
        bf16x8 qf[8]; float ss = 0.f;
#pragma unroll
        for (int d0 = 0; d0 < 8; ++d0) { const u32x4 w = *(const u32x4*)(Qp + d0 * 16); qf[d0] = __builtin_bit_cast(bf16x8, w);
#pragma unroll
            for (int e = 0; e < 4; ++e) { const float x0 = bf_lo(w[e]), x1 = bf_hi(w[e]); ss += x0 * x0 + x1 * x1; } }
        ss = pair_sum(ss);
        const float cs = __builtin_amdgcn_rsqf(ss * (1.f / 128.f) + EPS) * SCL;
        f32x16 o[4];
#pragma unroll
        for (int db = 0; db < 4; ++db)
#pragma unroll
            for (int r = 0; r < 16; ++r) o[db][r] = 0.f;
        float l = 0.f;
#pragma unroll 1
        for (int kb = 0; kb < 8; ++kb) {
            f32x16 z;
#pragma unroll
            for (int r = 0; r < 16; ++r) z[r] = 0.f;
#pragma unroll
            for (int d0 = 0; d0 < 8; ++d0) { const bf16x8 kf = *(LAS const bf16x8*)(krd + kb * 32 * XK_STR + d0 * 32); z = MFMA32(kf, qf[d0], z); }
            float ev[16];
#pragma unroll
            for (int r = 0; r < 16; ++r) { ev[r] = __builtin_amdgcn_exp2f(z[r] * cs - MB); l += ev[r]; }
            bf16x8 pa[2];
            { u32x4 w0, w1;
#pragma unroll
              for (int e = 0; e < 4; ++e) { w0[e] = pk2(ev[2 * e], ev[2 * e + 1]); w1[e] = pk2(ev[8 + 2 * e], ev[8 + 2 * e + 1]); }
              pa[0] = __builtin_bit_cast(bf16x8, w0); pa[1] = __builtin_bit_cast(bf16x8, w1); }
#pragma unroll
            for (int s = 0; s < 2; ++s)
#pragma unroll
                for (int db = 0; db < 4; ++db) { LAS const unsigned char* p = vrd + (kb * 32 + 16 * s) * XV_STR + db * 64;
                    const s16x4 lo = tr16(p), hi = tr16(p + 8 * XV_STR);
                    o[db] = MFMA32(pa[s], ((bf16x8){lo[0], lo[1], lo[2], lo[3], hi[0], hi[1], hi[2], hi[3]}), o[db]); }
        }
        l = pair_sum(l);
        if (hh == 0) wsf[r32] = l;
        LDS_WAIT();
        bf16* Op = proj + qrow * PW + C_QM + h * 128 + r32;
#pragma unroll
        for (int r = 0; r < 16; ++r) { const float rl = __builtin_amdgcn_rcpf(wsf[crow(r, hh)]); bf16* p = Op + (size_t)crow(r, hh) * PW;
#pragma unroll
            for (int db = 0; db < 4; ++db) p[db * 32] = (bf16)(pk2(o[db][r] * rl, 0.f) & 0xffffu); }
        LDS_WAIT();
    }
}

#ifndef PG8_SP2
#define PG8_SP2 true
#endif
#ifndef PG8_ALIGN
#define PG8_ALIGN true
#endif
__global__ void __launch_bounds__(NTHREADS, 2) mega_fwd(Args a) {
    extern __shared__ __attribute__((aligned(16))) unsigned char lds_raw[];
    LAS unsigned char* lds = (LAS unsigned char*)lds_raw;
    cg::grid_group grid = cg::this_grid();
    const int tid = threadIdx.x, lane = tid & 63, wave = __builtin_amdgcn_readfirstlane(tid >> 6);
    const int G = gridDim.x;
    unsigned char* ws = a.ws;
    float* ssq = (float*)(ws + WS_SSQ);
    bf16* xb = (bf16*)(ws + WS_XB); bf16* proj = (bf16*)(ws + WS_PROJ); bf16* hid = (bf16*)(ws + WS_HID);
    bf16* mkv = (bf16*)(ws + WS_MKV);

    prologue(a, lds, wave, lane, tid);
    grid.sync();
    {
        pg8::Gemm g{(const bf16*)(ws + WS_MEMN), (const bf16*)(ws + WS_WKV), MROWS, MKVW, DM, DM}; pg8::StaticOrder S; S.init(MROWS, MKVW, G, (int)blockIdx.x);
        pg8::EpiScale E{mkv, MKVW, nullptr};
        pg8::gemm_phase<pg8::EpiScale, pg8::StaticOrder, PG8_ALIGN, PG8_SP2>(lds, g, S, E);
    }
#pragma unroll 1
    for (int L = 0; L < DEPTH; ++L) {
        {
            pg8::Gemm g{xb, (const bf16*)(ws + WS_WIN + L * SZ_WIN), MTOK, PW, DM, DM}; pg8::StaticOrder S; S.init(MTOK, PW, G, (int)blockIdx.x);
            pg8::EpiScale E{proj, PW, ssq + (size_t)(2 * L) * MTOK};
            pg8::gemm_phase<pg8::EpiScale, pg8::StaticOrder, PG8_ALIGN, PG8_SP2>(lds, g, S, E);
        }
        grid.sync();
        if (L & 1) sb_phase(proj, lds, wave, lane);
        else conv_phase(proj, a.in[5] + (size_t)(L >> 1) * 3 * 1024, tid);
        cross_phase(proj, mkv, a.in[11] + L * 128, a.in[12] + L * 128, L, lds, wave, lane, tid);
        grid.sync();
        {
            pg8::Gemm g{proj, (const bf16*)(ws + WS_WOUT + L * SZ_WOUT), MTOK, DM, KOUT, PW}; pg8::StaticOrder S; S.init(MTOK, DM, G, (int)blockIdx.x);
            pg8::EpiResid E{L == 0 ? a.in[0] : a.out, a.out, xb, ssq + (size_t)(2 * L + 1) * MTOK};
            pg8::gemm_phase<pg8::EpiResid, pg8::StaticOrder, PG8_ALIGN, PG8_SP2>(lds, g, S, E);
        }
        grid.sync();
        {
            pg8::Gemm g{xb, (const bf16*)(ws + WS_WFI + L * SZ_WFI), MTOK, NFF, DM, DM}; pg8::StaticOrder S; S.init(MTOK, NFF, G, (int)blockIdx.x);
            pg8::EpiSwiglu E{hid, DFF, ssq + (size_t)(2 * L + 1) * MTOK};
            pg8::gemm_phase<pg8::EpiSwiglu, pg8::StaticOrder, PG8_ALIGN, PG8_SP2>(lds, g, S, E);
        }
        grid.sync();
        {
            pg8::Gemm g{hid, (const bf16*)(ws + WS_WFO + L * SZ_WFO), MTOK, DM, DFF, DFF}; pg8::StaticOrder S; S.init(MTOK, DM, G, (int)blockIdx.x);
            pg8::EpiResid E{a.out, a.out, xb, ssq + (size_t)(2 * L + 2) * MTOK};
            pg8::gemm_phase<pg8::EpiResid, pg8::StaticOrder, PG8_ALIGN, PG8_SP2>(lds, g, S, E);
        }
        if (L + 1 < DEPTH) grid.sync();
    }
}

extern "C" void kernel_launch(void* const* d_in, const int* in_sizes, int n_in, void* d_out, int out_size, void* d_ws, size_t ws_size, hipStream_t stream) {
    static int grid = 0;
    if (grid == 0) {
        if (n_in != 13 || in_sizes[0] != MTOK * DM || out_size != MTOK * DM || ws_size < WS_END) { fprintf(stderr, "kernel_launch: unexpected shapes / workspace (n_in %d, ws %zu)\n", n_in, ws_size); grid = -1; return; }
        int dev = 0, cus = 0, per_cu = 0;
        hipGetDevice(&dev); hipDeviceGetAttribute(&cus, hipDeviceAttributeMultiprocessorCount, dev);
        if (hipFuncSetAttribute((const void*)mega_fwd, hipFuncAttributeMaxDynamicSharedMemorySize, LDS_BYTES) != hipSuccess) { fprintf(stderr, "kernel_launch: hipFuncSetAttribute failed\n"); grid = -1; return; }
        if (hipOccupancyMaxActiveBlocksPerMultiprocessor(&per_cu, (const void*)mega_fwd, NTHREADS, LDS_BYTES) != hipSuccess || per_cu < 1) { fprintf(stderr, "kernel_launch: occupancy query says %d\n", per_cu); (void)hipGetLastError(); per_cu = 1; }
        grid = cus;
    }
    if (grid < 0) return;
    Args a{};
    for (int i = 0; i < 13; ++i) a.in[i] = (const float*)d_in[i];
    a.out = (float*)d_out; a.ws = (unsigned char*)d_ws;
    void* args[] = {&a};
    hipError_t e = hipLaunchCooperativeKernel((const void*)mega_fwd, dim3(grid), dim3(NTHREADS), args, LDS_BYTES, stream);
    if (e != hipSuccess) fprintf(stderr, "cooperative launch failed: %s (grid %d)\n", hipGetErrorString(e), grid);
}
```
